# Optimizing an MI355X kernel written in HIP

```python
import jax, jax.numpy as jnp
from jax import lax
import numpy as np

D_MODEL = 1024
BATCH = 2
SEQ = 8192
DEPTH = 1
DEC_BATCH = 8
DEC_SEQ = 16
PAST_LEN = 4096

CHUNK = 64
HEAD_DIM = 64
A_HEADS = 6
A_LEFT_CHUNKS = 8
A_REACH = A_LEFT_CHUNKS * CHUNK
REL_CLIP = 128
B_HEADS = 6
B_KV_HEADS = 2
B_GROUP = B_HEADS // B_KV_HEADS
B_WINDOW = 128
B_LEFT_CHUNKS = B_WINDOW // CHUNK
B_REACH = B_LEFT_CHUNKS * CHUNK
M_HEADS = 4
N_MEM = 256
A_W = A_HEADS * HEAD_DIM
B_W = B_HEADS * HEAD_DIM
B_KVW = B_KV_HEADS * HEAD_DIM
M_W = M_HEADS * HEAD_DIM
D_MIX = A_W + B_W + M_W
SPLIT_SIZES = (A_W, A_W, A_W, A_W, B_W, B_KVW, B_KVW, B_W, M_W, M_W)
D_IN = sum(SPLIT_SIZES)
EPS = 1e-6
NEG = -1e30
SCALE = HEAD_DIM ** -0.5

kernel_name = "hybrid_chunk_streaming_encoder_step"


def _rmsnorm(x, g):
    xf = x.astype(jnp.float32)
    xf = xf * lax.rsqrt(jnp.mean(xf * xf, axis=-1, keepdims=True) + EPS)
    return (xf * g.astype(jnp.float32)).astype(x.dtype)


def _heads(t, h):
    return t.reshape(*t.shape[:-1], h, HEAD_DIM)


def _alibi_slopes():
    return 2.0 ** (-8.0 * jnp.arange(1, B_HEADS + 1, dtype=jnp.float32) / B_HEADS)


def _relpos_bias(table, d):
    return table[:, jnp.clip(d, -REL_CLIP, REL_CLIP) + REL_CLIP].astype(jnp.float32)[:, None]


def _alibi_bias(d):
    b = -_alibi_slopes()[:, None, None] * jnp.abs(d).astype(jnp.float32)[None]
    return b.reshape(B_KV_HEADS, B_GROUP, *d.shape)


def _attn_core(q, k, v, bias, valid, sink):
    s = jnp.einsum('...qhgd,...khd->...hgqk', q, k).astype(jnp.float32) * SCALE
    if bias is not None:
        s = s + bias
    if valid is not None:
        s = jnp.where(valid[..., None, None, None, :], s, NEG)
    if sink is None:
        p = jax.nn.softmax(s, axis=-1)
    else:
        sk = sink.astype(jnp.float32).reshape(q.shape[-3], q.shape[-2], 1, 1)
        m = jnp.maximum(jnp.max(s, axis=-1, keepdims=True), sk)
        e = jnp.exp(s - m)
        p = e / (jnp.sum(e, axis=-1, keepdims=True) + jnp.exp(sk - m))
    return jnp.einsum('...hgqk,...khd->...qhgd', p.astype(v.dtype), v)


def _band_attention(q, k, v, left_chunks, bias, sink):
    b, s = q.shape[:2]
    nc = s // CHUNK
    qc = q.reshape(b, nc, CHUNK, *q.shape[2:])
    kc = k.reshape(b, nc, CHUNK, *k.shape[2:])
    vc = v.reshape(b, nc, CHUNK, *v.shape[2:])
    band = jnp.arange(nc)[:, None] + jnp.arange(-left_chunks, 1)[None, :]
    valid = jnp.repeat(band >= 0, CHUNK, axis=1)
    band = jnp.maximum(band, 0)
    n_keys = (left_chunks + 1) * CHUNK
    kb = kc[:, band].reshape(b, nc, n_keys, *k.shape[2:])
    vb = vc[:, band].reshape(b, nc, n_keys, *v.shape[2:])
    o = _attn_core(qc, kb, vb, bias, valid, sink)
    return o.reshape(b, s, -1)


def _band_distance(left_chunks):
    n_keys = (left_chunks + 1) * CHUNK
    return left_chunks * CHUNK + jnp.arange(CHUNK)[:, None] - jnp.arange(n_keys)[None, :]


def _project(x, g_pre, w_in):
    z = _rmsnorm(x, g_pre) @ w_in
    return jnp.split(z, np.cumsum(SPLIT_SIZES)[:-1].tolist(), axis=-1)


def _mem_kv(mem, g_mem, w_mem_kv):
    mk, mv = jnp.split(_rmsnorm(mem, g_mem) @ w_mem_kv, 2, axis=-1)
    return _heads(mk, M_HEADS), _heads(mv, M_HEADS)


def _merge(x, oa, ga, ob, gb, om, gm, w_out, g_post):
    o = jnp.concatenate([oa * jax.nn.silu(ga), ob * jax.nn.silu(gb), om * jax.nn.silu(gm)], axis=-1) @ w_out
    return x + _rmsnorm(o, g_post)


def _gqa_q(t):
    return _heads(t, B_HEADS).reshape(*t.shape[:-1], B_KV_HEADS, B_GROUP, HEAD_DIM)


def setup_inputs(seed: int = 0) -> dict:
    key = jax.random.key(seed)
    ks = jax.random.split(key, 17)
    f32 = jnp.float32
    la = min(A_REACH, PAST_LEN)
    lb = min(B_REACH, PAST_LEN)
    return {
        "x_prompt": jax.random.normal(ks[0], (BATCH, SEQ, D_MODEL), f32),
        "x_sample": jax.random.normal(ks[1], (DEC_BATCH, DEC_SEQ, D_MODEL), f32),
        "cache_a_k": jax.random.normal(ks[2], (DEPTH, DEC_BATCH, la, A_HEADS, HEAD_DIM), f32),
        "cache_a_v": jax.random.normal(ks[3], (DEPTH, DEC_BATCH, la, A_HEADS, HEAD_DIM), f32),
        "cache_b_k": jax.random.normal(ks[4], (DEPTH, DEC_BATCH, lb, B_KV_HEADS, HEAD_DIM), f32),
        "cache_b_v": jax.random.normal(ks[5], (DEPTH, DEC_BATCH, lb, B_KV_HEADS, HEAD_DIM), f32),
        "cache_mem_k": jax.random.normal(ks[6], (DEPTH, DEC_BATCH, N_MEM, M_HEADS, HEAD_DIM), f32),
        "cache_mem_v": jax.random.normal(ks[7], (DEPTH, DEC_BATCH, N_MEM, M_HEADS, HEAD_DIM), f32),
        "mem_prompt": jax.random.normal(ks[8], (BATCH, N_MEM, D_MODEL), f32),
        "g_pre": 1.0 + 0.02 * jax.random.normal(ks[9], (DEPTH, D_MODEL), f32),
        "w_in": jax.random.normal(ks[10], (DEPTH, D_MODEL, D_IN), f32) * D_MODEL ** -0.5,
        "rel_bias_a": 0.1 * jax.random.normal(ks[11], (DEPTH, A_HEADS, 2 * REL_CLIP + 1), f32),
        "sink_b": 0.5 * jax.random.normal(ks[12], (DEPTH, B_HEADS), f32),
        "g_mem": 1.0 + 0.02 * jax.random.normal(ks[13], (DEPTH, D_MODEL), f32),
        "w_mem_kv": jax.random.normal(ks[14], (DEPTH, D_MODEL, 2 * M_W), f32) * D_MODEL ** -0.5,
        "w_out": jax.random.normal(ks[15], (DEPTH, D_MIX, D_MODEL), f32) * D_MIX ** -0.5,
        "g_post": 1.0 + 0.02 * jax.random.normal(ks[16], (DEPTH, D_MODEL), f32),
    }


def reference(x_prompt, x_sample, cache_a_k, cache_a_v, cache_b_k, cache_b_v, cache_mem_k, cache_mem_v,
              mem_prompt, g_pre, w_in, rel_bias_a, sink_b, g_mem, w_mem_kv, w_out, g_post):
    seq = x_prompt.shape[1]
    n_new = x_sample.shape[1]
    la_p = min(A_REACH, seq)
    lb_p = min(B_REACH, seq)
    la_s = cache_a_k.shape[2]
    lb_s = cache_b_k.shape[2]

    d_a_prompt = _band_distance(A_LEFT_CHUNKS)
    d_b_prompt = _band_distance(B_LEFT_CHUNKS)
    q_pos = PAST_LEN + jnp.arange(n_new)
    k_pos_a = jnp.concatenate([PAST_LEN - la_s + jnp.arange(la_s), q_pos])
    k_pos_b = jnp.concatenate([PAST_LEN - lb_s + jnp.arange(lb_s), q_pos])
    d_a_sample = q_pos[:, None] - k_pos_a[None, :]
    d_b_sample = q_pos[:, None] - k_pos_b[None, :]
    bias_b_prompt = _alibi_bias(d_b_prompt)
    bias_b_sample = _alibi_bias(d_b_sample)

    yp, ys = x_prompt, x_sample
    akp, avp, bkp, bvp, mkp, mvp, aks, avs, bks, bvs = ([] for _ in range(10))
    for l in range(DEPTH):
        qa, ka, va, ga, qb, kb, vb, gb, qm, gm = _project(yp, g_pre[l], w_in[l])
        ka, va = _heads(ka, A_HEADS), _heads(va, A_HEADS)
        kb, vb = _heads(kb, B_KV_HEADS), _heads(vb, B_KV_HEADS)
        oa = _band_attention(_heads(qa, A_HEADS)[..., None, :], ka, va, A_LEFT_CHUNKS,
                             _relpos_bias(rel_bias_a[l], d_a_prompt), None)
        ob = _band_attention(_gqa_q(qb), kb, vb, B_LEFT_CHUNKS, bias_b_prompt, sink_b[l])
        mk, mv = _mem_kv(mem_prompt, g_mem[l], w_mem_kv[l])
        om = _attn_core(_heads(qm, M_HEADS)[..., None, :], mk, mv, None, None, None)
        om = om.reshape(*om.shape[:2], M_W)
        yp = _merge(yp, oa, ga, ob, gb, om, gm, w_out[l], g_post[l])
        akp.append(ka[:, seq - la_p:]); avp.append(va[:, seq - la_p:])
        bkp.append(kb[:, seq - lb_p:]); bvp.append(vb[:, seq - lb_p:])
        mkp.append(mk); mvp.append(mv)

        qa, ka, va, ga, qb, kb, vb, gb, qm, gm = _project(ys, g_pre[l], w_in[l])
        ka, va = _heads(ka, A_HEADS), _heads(va, A_HEADS)
        kb, vb = _heads(kb, B_KV_HEADS), _heads(vb, B_KV_HEADS)
        ka_all = jnp.concatenate([cache_a_k[l].astype(ka.dtype), ka], axis=1)
        va_all = jnp.concatenate([cache_a_v[l].astype(va.dtype), va], axis=1)
        kb_all = jnp.concatenate([cache_b_k[l].astype(kb.dtype), kb], axis=1)
        vb_all = jnp.concatenate([cache_b_v[l].astype(vb.dtype), vb], axis=1)
        oa = _attn_core(_heads(qa, A_HEADS)[..., None, :], ka_all, va_all,
                        _relpos_bias(rel_bias_a[l], d_a_sample), None, None)
        oa = oa.reshape(*oa.shape[:2], A_W)
        ob = _attn_core(_gqa_q(qb), kb_all, vb_all, bias_b_sample, None, sink_b[l])
        ob = ob.reshape(*ob.shape[:2], B_W)
        om = _attn_core(_heads(qm, M_HEADS)[..., None, :], cache_mem_k[l], cache_mem_v[l], None, None, None)
        om = om.reshape(*om.shape[:2], M_W)
        ys = _merge(ys, oa, ga, ob, gb, om, gm, w_out[l], g_post[l])
        aks.append(ka); avs.append(va); bks.append(kb); bvs.append(vb)

    state_a_k_prompt = jnp.stack(akp)
    state_a_v_prompt = jnp.stack(avp)
    state_b_k_prompt = jnp.stack(bkp)
    state_b_v_prompt = jnp.stack(bvp)
    state_mem_k_prompt = jnp.stack(mkp)
    state_mem_v_prompt = jnp.stack(mvp)
    state_a_k_sample = jnp.stack(aks)
    state_a_v_sample = jnp.stack(avs)
    state_b_k_sample = jnp.stack(bks)
    state_b_v_sample = jnp.stack(bvs)
    return (yp, ys, state_a_k_prompt, state_a_v_prompt, state_b_k_prompt, state_b_v_prompt,
            state_mem_k_prompt, state_mem_v_prompt, state_a_k_sample, state_a_v_sample,
            state_b_k_sample, state_b_v_sample)
```

```cpp
#include <hip/hip_runtime.h>
#include <cstdint>
#include <cstdio>

constexpr int DM = 1024, BATCH = 2, SEQ = 8192, MP = BATCH * SEQ, DECB = 8, DECS = 16, MS = DECB * DECS, NMEM = 256, MM = BATCH * NMEM;
constexpr int DIN = 3072;
constexpr int C_QA = 0, C_KA = 384, C_VA = 768, C_GA = 1152, C_QB = 1536, C_KB = 1920, C_VB = 2048, C_GB = 2176, C_QM = 2560, C_GM = 2816;
constexpr float EPS = 1e-6f;
constexpr size_t O_YP = 0, O_YS = 16777216, O_SAKP = 16908288, O_SAVP = 17301504, O_SBKP = 17694720, O_SBVP = 17727488,
                 O_SMKP = 17760256, O_SMVP = 17891328, O_SAKS = 18022400, O_SAVS = 18071552, O_SBKS = 18120704, O_SBVS = 18137088;

typedef unsigned short bf16_t;
__device__ __forceinline__ float bf2f(bf16_t v) { return __uint_as_float(((unsigned)v) << 16); }
__device__ __forceinline__ bf16_t f2bf(float f) { unsigned u = __float_as_uint(f); return (bf16_t)((u + 0x7fffu + ((u >> 16) & 1u)) >> 16); }

__global__ void rstd_rows(const float* x, float* rstd, int rows) {
    int w = (blockIdx.x * blockDim.x + threadIdx.x) >> 6, lane = threadIdx.x & 63;
    if (w >= rows) return;
    const float* r = x + (size_t)w * DM; float s = 0.f;
    for (int i = lane; i < DM; i += 64) { float v = r[i]; s += v * v; }
    for (int o = 32; o > 0; o >>= 1) s += __shfl_xor(s, o);
    if (lane == 0) rstd[w] = rsqrtf(s / DM + EPS);
}

struct EpiArgs { bf16_t* z; float* out; float* o32; };
template <int MODE, typename TA>
__global__ void __launch_bounds__(256) gemm_naive(const TA* A, const float* rs, const float* gk, const float* W, int M, int N, int K, EpiArgs E) {
    __shared__ float As[16][68];
    __shared__ float Bs[16][68];
    const int tx = threadIdx.x & 15, ty = threadIdx.x >> 4;
    const int m0 = blockIdx.y * 64, n0 = blockIdx.x * 64;
    float acc[4][4] = {};
    for (int k0 = 0; k0 < K; k0 += 16) {
        for (int i = threadIdx.x; i < 1024; i += 256) {
            int r = i >> 4, kk = i & 15; float v;
            if constexpr (sizeof(TA) == 2) v = bf2f(((const bf16_t*)A)[(size_t)(m0 + r) * K + k0 + kk]); else v = ((const float*)A)[(size_t)(m0 + r) * K + k0 + kk];
            if (gk) v *= gk[k0 + kk];
            As[kk][r] = v;
        }
        for (int i = threadIdx.x; i < 1024; i += 256) { int kk = i >> 6, c = i & 63; Bs[kk][c] = W[(size_t)(k0 + kk) * N + n0 + c]; }
        __syncthreads();
#pragma unroll
        for (int kk = 0; kk < 16; ++kk) {
            float a[4], b[4];
#pragma unroll
            for (int i = 0; i < 4; ++i) { a[i] = As[kk][ty * 4 + i]; b[i] = Bs[kk][tx * 4 + i]; }
#pragma unroll
            for (int i = 0; i < 4; ++i)
#pragma unroll
                for (int j = 0; j < 4; ++j) acc[i][j] += a[i] * b[j];
        }
        __syncthreads();
    }
#pragma unroll
    for (int i = 0; i < 4; ++i) {
        const int m = m0 + ty * 4 + i; const float sc = rs ? rs[m] : 1.f;
#pragma unroll
        for (int j = 0; j < 4; ++j) {
            const int n = n0 + tx * 4 + j; const float v = acc[i][j] * sc;
            if (MODE == 0) {
                E.z[(size_t)m * DIN + n] = f2bf(v);
                const int b = m / SEQ, t = m % SEQ;
                if (n >= C_KA && n < C_VA && t >= SEQ - 512) E.out[O_SAKP + ((size_t)b * 512 + (t - (SEQ - 512))) * 384 + (n - C_KA)] = v;
                if (n >= C_VA && n < C_GA && t >= SEQ - 512) E.out[O_SAVP + ((size_t)b * 512 + (t - (SEQ - 512))) * 384 + (n - C_VA)] = v;
                if (n >= C_KB && n < C_VB && t >= SEQ - 128) E.out[O_SBKP + ((size_t)b * 128 + (t - (SEQ - 128))) * 128 + (n - C_KB)] = v;
                if (n >= C_VB && n < C_GB && t >= SEQ - 128) E.out[O_SBVP + ((size_t)b * 128 + (t - (SEQ - 128))) * 128 + (n - C_VB)] = v;
            } else if (MODE == 1) {
                E.z[(size_t)(MP + m) * DIN + n] = f2bf(v);
                if (n >= C_KA && n < C_VA) E.out[O_SAKS + (size_t)m * 384 + (n - C_KA)] = v;
                if (n >= C_VA && n < C_GA) E.out[O_SAVS + (size_t)m * 384 + (n - C_VA)] = v;
                if (n >= C_KB && n < C_VB) E.out[O_SBKS + (size_t)m * 128 + (n - C_KB)] = v;
                if (n >= C_VB && n < C_GB) E.out[O_SBVS + (size_t)m * 128 + (n - C_VB)] = v;
            } else if (MODE == 2) {
                if (n < 256) E.out[O_SMKP + (size_t)m * 256 + n] = v; else E.out[O_SMVP + (size_t)m * 256 + (n - 256)] = v;
            } else {
                E.o32[(size_t)m * DM + n] = v;
            }
        }
    }
}

struct AttnArgs {
    const bf16_t* z; const float* out; bf16_t* og;
    const float *cak, *cav, *cbk, *cbv, *cmk, *cmv, *relb, *sink;
};
__device__ __forceinline__ float silu(float g) { return g / (1.f + __expf(-g)); }
__global__ void __launch_bounds__(64) attn_naive(AttnArgs a) {
    const int unit = blockIdx.x, head = blockIdx.y, i = threadIdx.x;
    const bool samp = unit >= 256;
    const int kind = head < 6 ? 0 : (head < 12 ? 1 : 2);
    const int h = kind == 0 ? head : (kind == 1 ? head - 6 : head - 12);
    int nq, row;
    int b, c = 0;
    if (!samp) { b = unit / 128; c = unit % 128; nq = 64; row = b * SEQ + c * 64 + i; } else { b = unit - 256; nq = 16; row = MP + b * 16 + i; }
    if (i >= nq) return;
    const int qcol = kind == 0 ? C_QA + h * 64 : (kind == 1 ? C_QB + h * 64 : C_QM + h * 64);
    const int gcol = kind == 0 ? C_GA + h * 64 : (kind == 1 ? C_GB + h * 64 : C_GM + h * 64);
    const int ocol = kind == 0 ? h * 64 : (kind == 1 ? 384 + h * 64 : 768 + h * 64);
    float q[64], o[64];
#pragma unroll
    for (int d = 0; d < 64; ++d) { q[d] = bf2f(a.z[(size_t)row * DIN + qcol + d]) * 0.125f; o[d] = 0.f; }
    float m = -INFINITY, l = 0.f;
    float slope = 0.f;
    if (kind == 1) { slope = exp2f(-8.f * (float)(h + 1) / 6.f); m = a.sink[h]; l = 1.f; }
    int nk;
    if (kind == 0) nk = samp ? 512 + 16 : 576; else if (kind == 1) nk = samp ? 128 + 16 : 192; else nk = 256;
    for (int j = 0; j < nk; ++j) {
        const float* kp32 = nullptr; const float* vp32 = nullptr; const bf16_t* kp16 = nullptr; const bf16_t* vp16 = nullptr;
        int dist = 0; bool valid = true;
        if (kind == 2) {
            if (!samp) { kp32 = a.out + O_SMKP + ((size_t)b * 256 + j) * 256 + h * 64; vp32 = a.out + O_SMVP + ((size_t)b * 256 + j) * 256 + h * 64; }
            else { kp32 = a.cmk + ((size_t)b * 256 + j) * 256 + h * 64; vp32 = a.cmv + ((size_t)b * 256 + j) * 256 + h * 64; }
        } else if (!samp) {
            const int left = kind == 0 ? 8 : 2;
            const int s = (c - left) * 64 + j;
            valid = s >= 0;
            dist = (c * 64 + i) - s;
            if (valid) {
                const size_t zr = (size_t)(b * SEQ + s) * DIN;
                if (kind == 0) { kp16 = a.z + zr + C_KA + h * 64; vp16 = a.z + zr + C_VA + h * 64; }
                else { kp16 = a.z + zr + C_KB + (h / 3) * 64; vp16 = a.z + zr + C_VB + (h / 3) * 64; }
            }
        } else {
            const int nc = kind == 0 ? 512 : 128;
            if (j < nc) {
                dist = nc + i - j;
                if (kind == 0) { kp32 = a.cak + (((size_t)b * 512 + j) * 6 + h) * 64; vp32 = a.cav + (((size_t)b * 512 + j) * 6 + h) * 64; }
                else { kp32 = a.cbk + (((size_t)b * 128 + j) * 2 + h / 3) * 64; vp32 = a.cbv + (((size_t)b * 128 + j) * 2 + h / 3) * 64; }
            } else {
                const int i2 = j - nc; dist = i - i2;
                const size_t zr = (size_t)(MP + b * 16 + i2) * DIN;
                if (kind == 0) { kp16 = a.z + zr + C_KA + h * 64; vp16 = a.z + zr + C_VA + h * 64; }
                else { kp16 = a.z + zr + C_KB + (h / 3) * 64; vp16 = a.z + zr + C_VB + (h / 3) * 64; }
            }
        }
        if (!valid) continue;
        float s = 0.f;
        if (kp32) {
#pragma unroll
            for (int d = 0; d < 64; ++d) s += q[d] * kp32[d];
        } else {
#pragma unroll
            for (int d = 0; d < 64; ++d) s += q[d] * bf2f(kp16[d]);
        }
        if (kind == 0) { int dd = dist < -128 ? -128 : (dist > 128 ? 128 : dist); s += a.relb[h * 257 + dd + 128]; }
        else if (kind == 1) { s -= slope * fabsf((float)dist); }
        const float mn = fmaxf(m, s), f = __expf(m - mn), p = __expf(s - mn);
        l = l * f + p; m = mn;
        if (vp32) {
#pragma unroll
            for (int d = 0; d < 64; ++d) o[d] = o[d] * f + p * vp32[d];
        } else {
#pragma unroll
            for (int d = 0; d < 64; ++d) o[d] = o[d] * f + p * bf2f(vp16[d]);
        }
    }
    const float il = 1.f / l;
#pragma unroll
    for (int d = 0; d < 64; ++d) {
        const float g = bf2f(a.z[(size_t)row * DIN + gcol + d]);
        a.og[(size_t)row * DM + ocol + d] = f2bf(o[d] * il * silu(g));
    }
}

__global__ void final_rows(const float* o32, const float* xp, const float* xs, const float* gpost, float* out) {
    int w = (blockIdx.x * blockDim.x + threadIdx.x) >> 6, lane = threadIdx.x & 63;
    if (w >= MP + MS) return;
    const float* r = o32 + (size_t)w * DM; float s = 0.f;
    for (int i = lane; i < DM; i += 64) { float v = r[i]; s += v * v; }
    for (int o = 32; o > 0; o >>= 1) s += __shfl_xor(s, o);
    const float rstd = rsqrtf(s / DM + EPS);
    const float* x = w < MP ? xp + (size_t)w * DM : xs + (size_t)(w - MP) * DM;
    float* y = w < MP ? out + O_YP + (size_t)w * DM : out + O_YS + (size_t)(w - MP) * DM;
    for (int i = lane; i < DM; i += 64) y[i] = x[i] + gpost[i] * r[i] * rstd;
}

extern "C" void kernel_launch(void* const* d_in, const int* in_sizes, int n_in, void* d_out, int out_size, void* d_ws, size_t ws_size, hipStream_t stream) {
    const float* xp = (const float*)d_in[0]; const float* xs = (const float*)d_in[1];
    const float* mem = (const float*)d_in[8]; const float* gpre = (const float*)d_in[9]; const float* win = (const float*)d_in[10];
    const float* gmem = (const float*)d_in[13]; const float* wmem = (const float*)d_in[14]; const float* wout = (const float*)d_in[15]; const float* gpost = (const float*)d_in[16];
    float* out = (float*)d_out;
    char* ws = (char*)d_ws;
    float* rstd = (float*)ws;
    bf16_t* z = (bf16_t*)(ws + (1u << 20));
    bf16_t* og = (bf16_t*)(ws + (1u << 20) + (size_t)(MP + MS) * DIN * 2);
    float* o32 = (float*)(ws + (1u << 20) + (size_t)(MP + MS) * DIN * 2 + (size_t)(MP + MS) * DM * 2);
    rstd_rows<<<MP / 4, 256, 0, stream>>>(xp, rstd, MP);
    rstd_rows<<<MS / 4, 256, 0, stream>>>(xs, rstd + MP, MS);
    rstd_rows<<<MM / 4, 256, 0, stream>>>(mem, rstd + MP + MS, MM);
    EpiArgs E{z, out, o32};
    gemm_naive<0, float><<<dim3(DIN / 64, MP / 64), 256, 0, stream>>>(xp, rstd, gpre, win, MP, DIN, DM, E);
    gemm_naive<1, float><<<dim3(DIN / 64, MS / 64), 256, 0, stream>>>(xs, rstd + MP, gpre, win, MS, DIN, DM, E);
    gemm_naive<2, float><<<dim3(512 / 64, MM / 64), 256, 0, stream>>>(mem, rstd + MP + MS, gmem, wmem, MM, 512, DM, E);
    AttnArgs a{z, out, og, (const float*)d_in[2], (const float*)d_in[3], (const float*)d_in[4], (const float*)d_in[5], (const float*)d_in[6], (const float*)d_in[7], (const float*)d_in[11], (const float*)d_in[12]};
    attn_naive<<<dim3(256 + 8, 16), 64, 0, stream>>>(a);
    gemm_naive<3, bf16_t><<<dim3(DM / 64, (MP + MS) / 64), 256, 0, stream>>>(og, nullptr, nullptr, wout, MP + MS, DM, DM, E);
    final_rows<<<(MP + MS) / 4, 256, 0, stream>>>(o32, xp, xs, gpost, out);
}
```
